# Optimizing an MI355X kernel written in HIP

```python
import jax, jax.numpy as jnp
from jax import lax
import numpy as np

D_MODEL = 1024
BATCH = 8
SEQ = 2048
DEPTH = 2

D_MIX = D_MODEL
D_POOL = D_MIX // 2
D_SGU = D_MIX - D_POOL
POOL_WINDOWS = (2, 4, 8, 16)
N_POOL_GROUPS = len(POOL_WINDOWS)
POOL_GROUP = D_POOL // N_POOL_GROUPS
N_SGU_HEADS = 4
SGU_HEAD = D_SGU // N_SGU_HEADS
CHUNK = 128
SPLITS = (D_POOL, 2 * D_POOL, 2 * D_POOL + D_SGU, 2 * D_POOL + 2 * D_SGU)
D_IN_PROJ = 2 * D_POOL + 3 * D_SGU
DEEPNORM_ALPHA = (2.0 * DEPTH) ** 0.25
DEEPNORM_BETA = (8.0 * DEPTH) ** -0.25
LN_EPS = 1e-5

kernel_name = "hybrid_pool_sgu_deepnorm_adaln"


def _layer_norm(x):
    xf = x.astype(jnp.float32)
    mu = jnp.mean(xf, axis=-1, keepdims=True)
    var = jnp.mean(jnp.square(xf - mu), axis=-1, keepdims=True)
    return ((xf - mu) * lax.rsqrt(var + LN_EPS)).astype(x.dtype)


def _pool_mixer(xa, w_pool, pool_scale):
    B, S, _ = xa.shape
    xg = xa.reshape(B, S, N_POOL_GROUPS, POOL_GROUP)
    cs = jnp.cumsum(xg.astype(jnp.float32), axis=1)
    cs = jnp.pad(cs, ((0, 0), (1, 0), (0, 0), (0, 0)))
    t = jnp.arange(S)
    pooled = []
    for g, w in enumerate(POOL_WINDOWS):
        lo = jnp.maximum(t + 1 - w, 0)
        cs_g = cs[:, :, g, :]
        win_sum = cs_g[:, 1:] - cs_g[:, lo]
        count = (t + 1 - lo).astype(jnp.float32)
        pooled.append(win_sum / count[None, :, None])
    pooled = jnp.stack(pooled, axis=2).astype(xa.dtype) - xg
    y = jnp.einsum('bsgc,gcd->bsgd', pooled, w_pool)
    return y.reshape(B, S, D_POOL) * pool_scale


def _sgu_mixer(u, v, ln_g, ln_b, w_s, b_s):
    B, S, _ = u.shape
    n_chunks = S // CHUNK
    v = v.reshape(B, n_chunks, CHUNK, N_SGU_HEADS, SGU_HEAD)
    v = _layer_norm(v) * ln_g + ln_b
    causal = jnp.tril(jnp.ones((CHUNK, CHUNK), dtype=bool))
    w = jnp.where(causal[None], w_s, 0)
    mixed = jnp.einsum('hts,bnshd->bnthd', w, v) + jnp.transpose(b_s)[:, :, None]
    return u * mixed.reshape(B, S, D_SGU)


def _hybrid_layer(x, c, w_ada, b_ada, w_in, w_pool, pool_scale,
                  sgu_ln_g, sgu_ln_b, w_sgu, b_sgu, w_out, ln_g, ln_b):
    mod = jax.nn.silu(c) @ w_ada + b_ada
    shift, scale, gate = jnp.split(mod, 3, axis=-1)
    h = _layer_norm(x) * (1 + scale[:, None]) + shift[:, None]
    proj = h @ w_in
    xa, ga, u, v, gb = jnp.split(proj, SPLITS, axis=-1)
    ya = _pool_mixer(xa, w_pool, pool_scale) * jax.nn.silu(ga)
    yb = _sgu_mixer(jax.nn.gelu(u, approximate=False), jax.nn.gelu(v, approximate=False),
                    sgu_ln_g, sgu_ln_b, w_sgu, b_sgu) * jax.nn.silu(gb)
    y = jnp.concatenate([ya, yb], axis=-1) @ w_out
    z = DEEPNORM_ALPHA * x + gate[:, None] * y
    return _layer_norm(z) * ln_g + ln_b


def setup_inputs(seed: int = 0) -> dict:
    key = jax.random.key(seed)
    ks = jax.random.split(key, 16)
    f32 = jnp.float32
    x = jax.random.normal(ks[0], (BATCH, SEQ, D_MODEL), f32)
    c = jax.random.normal(ks[1], (BATCH, D_MODEL), f32)
    w_ada = jax.random.normal(ks[2], (DEPTH, D_MODEL, 3 * D_MODEL), f32) * (0.5 * D_MODEL ** -0.5)
    b_ada = jax.random.normal(ks[3], (DEPTH, 3 * D_MODEL), f32) * 0.02
    w_in = jax.random.normal(ks[4], (DEPTH, D_MODEL, D_IN_PROJ), f32) * D_MODEL ** -0.5
    w_pool = jax.random.normal(ks[5], (DEPTH, N_POOL_GROUPS, POOL_GROUP, POOL_GROUP), f32) * POOL_GROUP ** -0.5
    pool_scale = 1.0 + 0.1 * jax.random.normal(ks[6], (DEPTH, D_POOL), f32)
    sgu_ln_g = 1.0 + 0.1 * jax.random.normal(ks[7], (DEPTH, N_SGU_HEADS, SGU_HEAD), f32)
    sgu_ln_b = 0.02 * jax.random.normal(ks[8], (DEPTH, N_SGU_HEADS, SGU_HEAD), f32)
    w_sgu = jax.random.normal(ks[9], (DEPTH, N_SGU_HEADS, CHUNK, CHUNK), f32) * CHUNK ** -0.5
    b_sgu = 1.0 + 0.1 * jax.random.normal(ks[10], (DEPTH, N_SGU_HEADS, CHUNK), f32)
    w_out = jax.random.normal(ks[11], (DEPTH, D_MIX, D_MODEL), f32) * (D_MIX ** -0.5 * DEEPNORM_BETA)
    ln_g = 1.0 + 0.1 * jax.random.normal(ks[12], (DEPTH, D_MODEL), f32)
    ln_b = 0.02 * jax.random.normal(ks[13], (DEPTH, D_MODEL), f32)
    return {"x": x, "c": c, "w_ada": w_ada, "b_ada": b_ada, "w_in": w_in,
            "w_pool": w_pool, "pool_scale": pool_scale, "sgu_ln_g": sgu_ln_g,
            "sgu_ln_b": sgu_ln_b, "w_sgu": w_sgu, "b_sgu": b_sgu, "w_out": w_out,
            "ln_g": ln_g, "ln_b": ln_b}


def reference(x, c, w_ada, b_ada, w_in, w_pool, pool_scale, sgu_ln_g, sgu_ln_b,
              w_sgu, b_sgu, w_out, ln_g, ln_b):
    for l in range(DEPTH):
        x = _hybrid_layer(x, c, w_ada[l], b_ada[l], w_in[l], w_pool[l], pool_scale[l],
                          sgu_ln_g[l], sgu_ln_b[l], w_sgu[l], b_sgu[l], w_out[l],
                          ln_g[l], ln_b[l])
    return x
```

```cpp
#include <hip/hip_runtime.h>
#include <hip/hip_cooperative_groups.h>
#include <cstdio>
namespace cg = cooperative_groups;
namespace pg8 {
#define PG8_LAS __attribute__((address_space(3)))
typedef unsigned short bf16_t;
typedef short bf16x8 __attribute__((ext_vector_type(8)));
typedef float f32x4 __attribute__((ext_vector_type(4)));
typedef unsigned u32x4 __attribute__((ext_vector_type(4)));
constexpr int BM = 256, BK = 64, HALF = 128, HTB = HALF * BK * 2  , STAGE_BYTES = 8 * HTB, NXCD = 8, WGM = 8;

__host__ __device__ __forceinline__ int lds_byte(int r, int c) { const int st = (r >> 4) * 2 + (c >> 5), rr = r & 15, cc = c & 31, ob = rr * 64 + cc * 2; return st * 1024 + (ob ^ (((ob >> 9) & 1) << 5)); }
__host__ __device__ __forceinline__ void stage_rc(int b, int& R, int& C) { const int st = b / 1024, sb = b % 1024, swz = sb ^ (((sb >> 9) & 1) << 5); R = (st >> 1) * 16 + swz / 64; C = (st & 1) * 32 + (swz % 64) / 2; }
__host__ __device__ __forceinline__ int perm32(int rho) { const int n = rho >> 4, i = rho & 15; return 8 * (i >> 2) + 4 * n + (i & 3); }

struct Unit { int pm, pn; };
struct Gemm { const bf16_t* A; const bf16_t* Bt; int M, N, K; };

struct StaticOrder {
    int nM, nN, nwg, G, c;
    __host__ __device__ void init(int M, int N, int G_, int c_) { nM = M / BM; nN = N / BM; nwg = nM * nN; G = G_; c = c_; }
    __host__ __device__ bool next(int i, Unit& u) const {
        const long L = (long)i * G + c; if (L >= nwg) return false;
        int wgid = (int)L; { const int q = nwg / NXCD, r = nwg % NXCD, xcd = wgid % NXCD, off = wgid / NXCD; wgid = (xcd < r ? xcd * (q + 1) : r * (q + 1) + (xcd - r) * q) + off; }
        const int nig = WGM * nN, gid = wgid / nig, fm = gid * WGM, gsz = (nM - fm) < WGM ? (nM - fm) : WGM;
        u.pm = fm + ((wgid % nig) % gsz); u.pn = (wgid % nig) / gsz; return true;
    }
    __device__ __forceinline__ void a_ready(const Unit&) const {}
    __device__ __forceinline__ void done(const Unit&) const {}
};
struct CountedOrder : StaticOrder {
    const unsigned* ready; unsigned need; unsigned* tmo;
    __device__ __forceinline__ void a_ready(const Unit& u) const {
        if (threadIdx.x < 64) {
            const unsigned long long t0 = __builtin_amdgcn_s_memrealtime(); unsigned polls = 0;
            while ((unsigned)__builtin_amdgcn_readfirstlane(__hip_atomic_load(ready + 64 * u.pm, __ATOMIC_RELAXED, __HIP_MEMORY_SCOPE_AGENT)) < need) {
                if ((++polls & 255u) == 0u && __builtin_amdgcn_readfirstlane(__hip_atomic_load(tmo, __ATOMIC_RELAXED, __HIP_MEMORY_SCOPE_AGENT)) != 0u) break;
                if (__builtin_amdgcn_s_memrealtime() - t0 > 2000000ull) {
                    if (threadIdx.x == 0) { unsigned expect = 0u; __hip_atomic_compare_exchange_strong(tmo + 1, &expect, 0x600u | (unsigned)(u.pm & 0xff), __ATOMIC_RELAXED, __ATOMIC_RELAXED, __HIP_MEMORY_SCOPE_AGENT); __hip_atomic_store(tmo, 1u, __ATOMIC_RELAXED, __HIP_MEMORY_SCOPE_AGENT); }
                    break; }
                __builtin_amdgcn_s_sleep(2); }
            __builtin_amdgcn_fence(__ATOMIC_ACQUIRE, "agent");
            asm volatile("s_waitcnt vmcnt(0)" ::: "memory");
        }
#if !defined(BROKEN_HOOK_NO_BARRIER)
        asm volatile("" ::: "memory"); __builtin_amdgcn_s_barrier(); asm volatile("" ::: "memory");
#endif
    }
};

__device__ __forceinline__ unsigned cvt_pk_bf16(float lo, float hi) { unsigned r; asm volatile("v_cvt_pk_bf16_f32 %0, %1, %2" : "=v"(r) : "v"(lo), "v"(hi)); return r; }
typedef float f32x2 __attribute__((ext_vector_type(2)));
__device__ __forceinline__ f32x2 gelu_pk(f32x2 v) {
    const f32x2 av = __builtin_elementwise_abs(v), d = av * 0.2316418882f + 1.0f;
    f32x2 t; t.x = __builtin_amdgcn_rcpf(d.x); t.y = __builtin_amdgcn_rcpf(d.y);
    f32x2 q = t * 0.5307027145f + (-0.7265760135f); q = q * t + 0.7107068705f; q = q * t + (-0.142248368f); q = q * t + 0.127414796f; q = q * t;
    const f32x2 s = (v * v) * (-0.72134752044f);
    f32x2 e; e.x = __builtin_amdgcn_exp2f(s.x); e.y = __builtin_amdgcn_exp2f(s.y);
    const f32x2 m = v * (q * e), r = v - m;
    f32x2 o; o.x = v.x < 0.f ? m.x : r.x; o.y = v.y < 0.f ? m.y : r.y; return o;
}
template <class Epi, class Sched, bool STAMP = false>
__device__ __forceinline__ void gemm_phase(PG8_LAS unsigned char* lds, const Gemm g, const Sched& S, const Epi& E, unsigned long long* stamps) {
    int tid_ = threadIdx.x; asm volatile("" : "+v"(tid_)); const int tid = tid_, wid = __builtin_amdgcn_readfirstlane(tid >> 6), lane = tid & 63, wr = wid >> 2, wc = wid & 3, fr = lane & 15, fq = lane >> 4;
    const int K = g.K, nt = K / BK;
    int ts_lo = 0, ts_hi = 0, nts = 0; const unsigned long long rt_entry = STAMP ? (unsigned long long)wall_clock64() : 0ull;
#define PG8_STAMP() do { if (STAMP && wid == 0 && nts < 64) { const unsigned long long _c = (unsigned long long)clock64(); \
        ts_lo = (lane == nts) ? (int)(unsigned)_c : ts_lo; ts_hi = (lane == nts) ? (int)(unsigned)(_c >> 32) : ts_hi; ++nts; } } while (0)
    PG8_STAMP();
    unsigned voffA[2], voffB[2];
#pragma unroll
    for (int i = 0; i < 2; ++i) { int R, C; stage_rc(tid * 16 + i * 8192, R, C); const int Rb = Epi::PERM ? ((R & ~31) + perm32(R & 31)) : R;
        voffA[i] = (unsigned)(R * K + C) * 2u; voffB[i] = (unsigned)(Rb * K + C) * 2u; }
    const size_t kstep = (size_t)(BK * 2);
    const size_t hstep = (size_t)HALF * K * 2;
    const size_t tstep = 2 * hstep;
    const unsigned ldsw = (unsigned)wid * 1024u;
    const int aoff = lds_byte(wr * 64 + fr, fq * 8), boff = lds_byte(wc * 32 + fr, fq * 8);
#define PG8_SA(b, h) (((b) * 2 + (h)) * HTB)
#define PG8_SB(b, h) ((4 + (b) * 2 + (h)) * HTB)
#define PG8_STAGE(bufoff, gbase, voff) do { _Pragma("unroll") for (int _i = 0; _i < 2; ++_i) \
        __builtin_amdgcn_global_load_lds((const unsigned*)((const char*)(gbase) + (voff)[_i]), (PG8_LAS unsigned*)(lds + (bufoff) + ldsw + _i * 8192), 16, 0, 0); } while (0)
#define PG8_LDA(dst, b, h) do { _Pragma("unroll") for (int m = 0; m < 4; ++m) _Pragma("unroll") for (int k = 0; k < 2; ++k) dst[m][k] = *(const PG8_LAS bf16x8*)(lds + PG8_SA(b, h) + aoff + m * 2048 + k * 1024); } while (0)
#define PG8_LDB(dst, b, h) do { _Pragma("unroll") for (int n = 0; n < 2; ++n) _Pragma("unroll") for (int k = 0; k < 2; ++k) dst[n][k] = *(const PG8_LAS bf16x8*)(lds + PG8_SB(b, h) + boff + n * 2048 + k * 1024); } while (0)
#define PG8_MMA(ai, bj, At, Bt) do { __builtin_amdgcn_s_setprio(1); _Pragma("unroll") for (int m = 0; m < 4; ++m) _Pragma("unroll") for (int n = 0; n < 2; ++n) _Pragma("unroll") for (int k = 0; k < 2; ++k) \
        acc[ai][bj][m][n] = __builtin_amdgcn_mfma_f32_16x16x32_bf16(Bt[n][k], At[m][k], acc[ai][bj][m][n], 0, 0, 0); __builtin_amdgcn_s_setprio(0); } while (0)
#define PG8_WAIT_V(n) asm volatile("s_waitcnt vmcnt(" #n ")" ::: "memory")
#define PG8_WAIT_L(n) asm volatile("s_waitcnt lgkmcnt(" #n ")" ::: "memory")
#define PG8_BAR __builtin_amdgcn_s_barrier()
#define PG8_SCHED __builtin_amdgcn_sched_barrier(0)
    Unit cur, nxt; int ui = 0;
    if (!S.next(0, cur)) return;
    f32x4 acc[2][2][4][2];
#pragma unroll
    for (int a = 0; a < 2; ++a)
#pragma unroll
        for (int b = 0; b < 2; ++b)
#pragma unroll
            for (int m = 0; m < 4; ++m)
#pragma unroll
                for (int n = 0; n < 2; ++n) acc[a][b][m][n] = (f32x4){0.f, 0.f, 0.f, 0.f};
    bf16x8 At[4][2], B0[2][2], B1[2][2];
    const char* cA = (const char*)g.A + (size_t)cur.pm * tstep; const char* cB = (const char*)g.Bt + (size_t)cur.pn * tstep;
    S.a_ready(cur);
    PG8_STAGE(PG8_SB(0, 0), cB, voffB); PG8_STAGE(PG8_SA(0, 0), cA, voffA); PG8_STAGE(PG8_SB(0, 1), cB + hstep, voffB); PG8_STAGE(PG8_SA(0, 1), cA + hstep, voffA);
    if (wr == 1) PG8_BAR;
    PG8_WAIT_V(4); PG8_BAR;
    PG8_STAGE(PG8_SB(1, 0), cB + kstep, voffB); PG8_STAGE(PG8_SA(1, 0), cA + kstep, voffA); PG8_STAGE(PG8_SB(1, 1), cB + hstep + kstep, voffB);
    PG8_WAIT_V(6); PG8_BAR;
    PG8_STAMP();
    for (;;) {
        const bool has_next = S.next(ui + 1, nxt);
        const char* nA = has_next ? (const char*)g.A + (size_t)nxt.pm * tstep : cA; const char* nB = has_next ? (const char*)g.Bt + (size_t)nxt.pn * tstep : cB;
        for (int t = 0; t < nt; t += 2) {
            const bool last = (t == nt - 2);
            const char* a1 = cA + (size_t)(t + 1) * kstep;
            const char* a2 = last ? nA : cA + (size_t)(t + 2) * kstep; const char* b2 = last ? nB : cB + (size_t)(t + 2) * kstep;
            const char* a3 = a2 + kstep; const char* b3 = b2 + kstep;
            if (last && has_next) S.a_ready(nxt);
            PG8_LDB(B0, 0, 0); PG8_SCHED; PG8_LDA(At, 0, 0); PG8_STAGE(PG8_SA(1, 1), a1 + hstep, voffA);
            PG8_WAIT_L(8); PG8_BAR; PG8_WAIT_L(0); PG8_MMA(0, 0, At, B0); PG8_BAR; PG8_SCHED;
            PG8_LDB(B1, 0, 1); PG8_STAGE(PG8_SB(0, 0), b2, voffB);
            PG8_BAR; PG8_WAIT_L(0); PG8_MMA(0, 1, At, B1); PG8_BAR;
            PG8_LDA(At, 0, 1); PG8_STAGE(PG8_SA(0, 0), a2, voffA);
            PG8_BAR; PG8_WAIT_L(0); PG8_MMA(1, 0, At, B0); PG8_BAR; PG8_SCHED;
            PG8_STAGE(PG8_SB(0, 1), b2 + hstep, voffB);
            PG8_WAIT_V(6); PG8_BAR; PG8_MMA(1, 1, At, B1); PG8_BAR;
            PG8_LDB(B0, 1, 0); PG8_SCHED; PG8_LDA(At, 1, 0); PG8_STAGE(PG8_SA(0, 1), a2 + hstep, voffA);
            PG8_WAIT_L(8); PG8_BAR; PG8_WAIT_L(0); PG8_MMA(0, 0, At, B0); PG8_BAR; PG8_SCHED;
            PG8_LDB(B1, 1, 1); PG8_STAGE(PG8_SB(1, 0), b3, voffB);
            PG8_BAR; PG8_WAIT_L(0); PG8_MMA(0, 1, At, B1); PG8_BAR;
            PG8_LDA(At, 1, 1); PG8_STAGE(PG8_SA(1, 0), a3, voffA);
            PG8_BAR; PG8_WAIT_L(0); PG8_MMA(1, 0, At, B0); PG8_BAR; PG8_SCHED;
            PG8_STAGE(PG8_SB(1, 1), b3 + hstep, voffB);
            PG8_WAIT_V(6); PG8_BAR; PG8_MMA(1, 1, At, B1); PG8_BAR;
        }
        PG8_STAMP();
        if constexpr (!Epi::AFTER_DRAIN) { E(acc, cur, wr, wc, fr, fq); S.done(cur); }
        PG8_STAMP();
        if (!has_next) break;
#pragma unroll
        for (int a = 0; a < 2; ++a)
#pragma unroll
            for (int b = 0; b < 2; ++b)
#pragma unroll
                for (int m = 0; m < 4; ++m)
#pragma unroll
                    for (int n = 0; n < 2; ++n) acc[a][b][m][n] = (f32x4){0.f, 0.f, 0.f, 0.f};
        cur = nxt; cA = nA; cB = nB; ++ui;
    }
    PG8_WAIT_V(0);
    if (wr == 0) PG8_BAR;
    PG8_BAR;
    if constexpr (Epi::AFTER_DRAIN) { E.fused(acc, cur, wr, wc, fr, fq, lds, wid, lane); S.done(cur); }
    PG8_STAMP();
    if (STAMP && wid == 0) { stamps[lane] = lane < nts ? (((unsigned long long)(unsigned)ts_hi << 32) | (unsigned)ts_lo) : 0ull;
        if (lane == 62) stamps[62] = rt_entry; if (lane == 63) stamps[63] = (unsigned long long)wall_clock64(); }
#undef PG8_STAMP
#undef PG8_SA
#undef PG8_SB
#undef PG8_STAGE
#undef PG8_LDA
#undef PG8_LDB
#undef PG8_MMA
#undef PG8_WAIT_V
#undef PG8_WAIT_L
#undef PG8_BAR
#undef PG8_SCHED
}
}

namespace mk {
using pg8::bf16_t; using pg8::bf16x8; using pg8::f32x4; using pg8::u32x4; using pg8::f32x2; using pg8::Unit; using pg8::cvt_pk_bf16; using pg8::gelu_pk;
typedef unsigned u32x2 __attribute__((ext_vector_type(2)));
#define LAS __attribute__((address_space(3)))

constexpr int NB = 8, SEQ = 2048, D = 1024, M = NB * SEQ, NP = 2560;
constexpr float ALPHA = 1.4142135623730951f;
constexpr float EPS = 1e-5f;
constexpr int LDS_BYTES = pg8::STAGE_BYTES;

constexpr size_t WS_MOD = 0;
constexpr size_t WS_WIN = WS_MOD + (size_t)2 * 8 * 3072 * 4;
constexpr size_t WS_WOUT = WS_WIN + (size_t)2 * NP * D * 2;
constexpr size_t WS_WPOOL = WS_WOUT + (size_t)2 * D * D * 2;
constexpr size_t WS_WSGU = WS_WPOOL + (size_t)2 * 4 * 128 * 128 * 2;
constexpr size_t WS_H = WS_WSGU + (size_t)2 * 4 * 128 * 128 * 2;
constexpr size_t WS_PROJ = WS_H + (size_t)M * D * 2;
constexpr size_t WS_Z = WS_PROJ + (size_t)M * NP * 2;
constexpr size_t WS_END = WS_Z + (size_t)M * D * 4;

struct Params { const float *x, *c, *w_ada, *b_ada, *w_in, *w_pool, *pool_scale, *sgu_ln_g, *sgu_ln_b, *w_sgu, *b_sgu, *w_out, *ln_g, *ln_b; float* out; unsigned char* ws; };

__device__ __forceinline__ int opaque_tid() { int t = threadIdx.x; asm volatile("" : "+v"(t)); return t; }
__device__ __forceinline__ float bf2f(unsigned short b) { return __uint_as_float((unsigned)b << 16); }
__device__ __forceinline__ unsigned short f2bf(float f) { unsigned u = __float_as_uint(f); u += 0x7FFFu + ((u >> 16) & 1u); return (unsigned short)(u >> 16); }
__device__ __forceinline__ float silu_f(float v) { return v * __builtin_amdgcn_rcpf(1.0f + __builtin_amdgcn_exp2f(-1.4426950408889634f * v)); }
__device__ __forceinline__ void unpack8(const u32x4 w, float (&f)[8]) {
    f[0] = __uint_as_float(w.x << 16); f[1] = __uint_as_float(w.x & 0xffff0000u); f[2] = __uint_as_float(w.y << 16); f[3] = __uint_as_float(w.y & 0xffff0000u);
    f[4] = __uint_as_float(w.z << 16); f[5] = __uint_as_float(w.z & 0xffff0000u); f[6] = __uint_as_float(w.w << 16); f[7] = __uint_as_float(w.w & 0xffff0000u);
}
__device__ __forceinline__ u32x4 pack8(const float (&f)[8]) { u32x4 w; w.x = cvt_pk_bf16(f[0], f[1]); w.y = cvt_pk_bf16(f[2], f[3]); w.z = cvt_pk_bf16(f[4], f[5]); w.w = cvt_pk_bf16(f[6], f[7]); return w; }

__device__ __forceinline__ void transpose_tile(const float* src, int ld_src, bf16_t* dst, int ld_dst, LAS float* tile, int tid) {
    __syncthreads();
#pragma unroll
    for (int pass = 0; pass < 2; ++pass) { const int r = pass * 32 + (tid >> 4), c4 = (tid & 15) * 4; const f32x4 v = *(const f32x4*)(src + (size_t)r * ld_src + c4);
        tile[r * 65 + c4 + 0] = v[0]; tile[r * 65 + c4 + 1] = v[1]; tile[r * 65 + c4 + 2] = v[2]; tile[r * 65 + c4 + 3] = v[3]; }
    __syncthreads();
    const int c = tid >> 3, r8 = (tid & 7) * 8; float f[8];
#pragma unroll
    for (int i = 0; i < 8; ++i) f[i] = tile[(r8 + i) * 65 + c];
    *(u32x4*)(dst + (size_t)c * ld_dst + r8) = pack8(f);
}
__device__ void p0_prologue(const Params& p, LAS unsigned char* lds) {
    const int tid = opaque_tid();
    LAS float* sc = (LAS float*)lds;
    LAS float* red = (LAS float*)(lds + 32768);
    LAS float* tile = (LAS float*)(lds + 49152);
    unsigned char* ws = p.ws;
    for (int i = tid; i < 8192; i += 512) sc[i] = silu_f(p.c[i]);
    __syncthreads();
    constexpr int N_MOD = 384, N_TIN = 1280, N_TOUT = 512, N_TPOOL = 32, N_SGU = 32, N_ALL = N_MOD + N_TIN + N_TOUT + N_TPOOL + N_SGU;
    for (int it = blockIdx.x; it < N_ALL; it += gridDim.x) {
        if (it < N_MOD) {
            const int l = it / 192, n0 = (it % 192) * 16, kq = tid >> 4, nn = tid & 15;
            const float* wp = p.w_ada + (size_t)l * 1024 * 3072 + (size_t)(kq * 32) * 3072 + n0 + nn;
            float acc[8];
#pragma unroll
            for (int b = 0; b < 8; ++b) acc[b] = 0.f;
#pragma unroll 8
            for (int kk = 0; kk < 32; ++kk) { const float w = wp[(size_t)kk * 3072];
#pragma unroll
                for (int b = 0; b < 8; ++b) acc[b] += sc[b * 1024 + kq * 32 + kk] * w; }
            __syncthreads();
#pragma unroll
            for (int b = 0; b < 8; ++b) red[kq * 128 + nn * 8 + b] = acc[b];
            __syncthreads();
            if (tid < 128) { float s = 0.f;
                for (int q = 0; q < 32; ++q) s += red[q * 128 + tid];
                const int n = n0 + (tid >> 3), b = tid & 7;
                ((float*)(ws + WS_MOD))[(size_t)(l * 8 + b) * 3072 + n] = s + p.b_ada[l * 3072 + n]; }
        } else if (it < N_MOD + N_TIN) {
            const int i2 = it - N_MOD, l = i2 / 640, r = i2 % 640, kt = r / 40, nt = r % 40;
            transpose_tile(p.w_in + (size_t)l * D * NP + (size_t)kt * 64 * NP + nt * 64, NP, (bf16_t*)(ws + WS_WIN) + (size_t)l * NP * D + (size_t)nt * 64 * D + kt * 64, D, tile, tid);
        } else if (it < N_MOD + N_TIN + N_TOUT) {
            const int i2 = it - N_MOD - N_TIN, l = i2 / 256, r = i2 % 256, kt = r / 16, nt = r % 16;
            transpose_tile(p.w_out + (size_t)l * D * D + (size_t)kt * 64 * D + nt * 64, D, (bf16_t*)(ws + WS_WOUT) + (size_t)l * D * D + (size_t)nt * 64 * D + kt * 64, D, tile, tid);
        } else if (it < N_MOD + N_TIN + N_TOUT + N_TPOOL) {
            const int i2 = it - N_MOD - N_TIN - N_TOUT, lg = i2 / 4, r = i2 % 4, kt = r / 2, nt = r % 2;
            transpose_tile(p.w_pool + (size_t)lg * 16384 + (size_t)kt * 64 * 128 + nt * 64, 128, (bf16_t*)(ws + WS_WPOOL) + (size_t)lg * 16384 + (size_t)nt * 64 * 128 + kt * 64, 128, tile, tid);
        } else {
            const int i2 = it - N_MOD - N_TIN - N_TOUT - N_TPOOL; const size_t e0 = (size_t)i2 * 4096 + (size_t)tid * 8;
            const int s0 = (int)(e0 & 127), t = (int)((e0 >> 7) & 127);
            const f32x4 a = *(const f32x4*)(p.w_sgu + e0), b = *(const f32x4*)(p.w_sgu + e0 + 4);
            float f[8] = {a[0], a[1], a[2], a[3], b[0], b[1], b[2], b[3]};
#pragma unroll
            for (int i = 0; i < 8; ++i) if (s0 + i > t) f[i] = 0.f;
            *(u32x4*)((bf16_t*)(ws + WS_WSGU) + e0) = pack8(f);
        }
    }
}

__device__ __forceinline__ void row_stats(const f32x4 (&v)[4], float& mean, float& rstd) {
    float s = 0.f;
#pragma unroll
    for (int i = 0; i < 4; ++i) s += (v[i][0] + v[i][1]) + (v[i][2] + v[i][3]);
#pragma unroll
    for (int o = 32; o >= 1; o >>= 1) s += __shfl_xor(s, o);
    mean = s * (1.0f / 1024.0f);
    float q = 0.f;
#pragma unroll
    for (int i = 0; i < 4; ++i) { const f32x4 d = v[i] - mean; q += (d[0] * d[0] + d[1] * d[1]) + (d[2] * d[2] + d[3] * d[3]); }
#pragma unroll
    for (int o = 32; o >= 1; o >>= 1) q += __shfl_xor(q, o);
    rstd = rsqrtf(q * (1.0f / 1024.0f) + EPS);
}
__device__ __forceinline__ void store_mod(const f32x4 (&v)[4], const float* modb, bf16_t* hrow, int lane) {
    float mean, rstd; row_stats(v, mean, rstd);
#pragma unroll
    for (int i = 0; i < 4; ++i) { const int col = i * 256 + lane * 4;
        const f32x4 sh = *(const f32x4*)(modb + col), scl = *(const f32x4*)(modb + 1024 + col);
        const f32x4 o = (v[i] - mean) * rstd * (scl + 1.0f) + sh;
        u32x2 w; w.x = cvt_pk_bf16(o[0], o[1]); w.y = cvt_pk_bf16(o[2], o[3]); *(u32x2*)(hrow + col) = w; }
}
__device__ void p1_lnmod(const float* src, const float* mod_l, bf16_t* hb) {
    const int tid = opaque_tid(), lane = tid & 63, wave = tid >> 6;
    for (int row = blockIdx.x * 8 + wave; row < M; row += gridDim.x * 8) {
        f32x4 v[4];
#pragma unroll
        for (int i = 0; i < 4; ++i) v[i] = *(const f32x4*)(src + (size_t)row * D + i * 256 + lane * 4);
        store_mod(v, mod_l + (size_t)(row >> 11) * 3072, hb + (size_t)row * D, lane);
    }
}
__device__ void p4_ln(const float* z, const float* g, const float* bta, float* out, const float* mod_next, bf16_t* hb) {
    const int tid = opaque_tid(), lane = tid & 63, wave = tid >> 6;
    for (int row = blockIdx.x * 8 + wave; row < M; row += gridDim.x * 8) {
        f32x4 v[4];
#pragma unroll
        for (int i = 0; i < 4; ++i) v[i] = *(const f32x4*)(z + (size_t)row * D + i * 256 + lane * 4);
        float mean, rstd; row_stats(v, mean, rstd);
#pragma unroll
        for (int i = 0; i < 4; ++i) { const int col = i * 256 + lane * 4;
            v[i] = (v[i] - mean) * rstd * *(const f32x4*)(g + col) + *(const f32x4*)(bta + col);
            *(f32x4*)(out + (size_t)row * D + col) = v[i]; }
        if (mod_next) store_mod(v, mod_next + (size_t)(row >> 11) * 3072, hb + (size_t)row * D, lane);
    }
}

struct EpiProj {
    static constexpr bool PERM = true, AFTER_DRAIN = false;
    bf16_t* O;
    template <int ACT> __device__ __forceinline__ void run(const f32x4 (&acc)[2][2][4][2], bf16_t* base) const {
#pragma unroll
        for (int ai = 0; ai < 2; ++ai)
#pragma unroll
            for (int m = 0; m < 4; ++m) { bf16_t* rowp = base + (size_t)(ai * 128 + m * 16) * NP;
#pragma unroll
                for (int bj = 0; bj < 2; ++bj) { f32x4 v0 = acc[ai][bj][m][0], v1 = acc[ai][bj][m][1];
                    if (ACT == 2) { const f32x2 a = gelu_pk((f32x2){v0[0], v0[1]}), b = gelu_pk((f32x2){v0[2], v0[3]}), c = gelu_pk((f32x2){v1[0], v1[1]}), d = gelu_pk((f32x2){v1[2], v1[3]});
                        v0 = (f32x4){a.x, a.y, b.x, b.y}; v1 = (f32x4){c.x, c.y, d.x, d.y}; }
                    if (ACT == 1) {
#pragma unroll
                        for (int j = 0; j < 4; ++j) { v0[j] = silu_f(v0[j]); v1[j] = silu_f(v1[j]); } }
                    u32x4 w; w.x = cvt_pk_bf16(v0[0], v0[1]); w.y = cvt_pk_bf16(v0[2], v0[3]); w.z = cvt_pk_bf16(v1[0], v1[1]); w.w = cvt_pk_bf16(v1[2], v1[3]);
                    *(u32x4*)(rowp + bj * 128) = w; } }
    }
    __device__ __forceinline__ void operator()(const f32x4 (&acc)[2][2][4][2], const Unit& u, int wr, int wc, int fr, int fq) const {
        bf16_t* base = O + (size_t)(u.pm * 256 + wr * 64 + fr) * NP + u.pn * 256 + wc * 32 + 8 * fq;
        const int pn = u.pn;
        if (pn < 2) run<0>(acc, base); else if (pn >= 4 && pn < 8) run<2>(acc, base); else run<1>(acc, base);
    }
};
struct EpiZ {
    static constexpr bool PERM = false, AFTER_DRAIN = false;
    const float* X; const float* gate; float* Z;
    __device__ __forceinline__ void operator()(const f32x4 (&acc)[2][2][4][2], const Unit& u, int wr, int wc, int fr, int fq) const {
        const int row0 = u.pm * 256 + wr * 64 + fr, col0 = u.pn * 256 + wc * 32 + 4 * fq;
        const float* gb = gate + (size_t)(u.pm >> 3) * 3072 + col0;
        f32x4 gv[2][2];
#pragma unroll
        for (int bj = 0; bj < 2; ++bj)
#pragma unroll
            for (int n = 0; n < 2; ++n) gv[bj][n] = *(const f32x4*)(gb + bj * 128 + n * 16);
#pragma unroll
        for (int ai = 0; ai < 2; ++ai)
#pragma unroll
            for (int m = 0; m < 4; ++m) { const size_t off = (size_t)(row0 + ai * 128 + m * 16) * D + col0;
#pragma unroll
                for (int bj = 0; bj < 2; ++bj)
#pragma unroll
                    for (int n = 0; n < 2; ++n) { const f32x4 xv = *(const f32x4*)(X + off + bj * 128 + n * 16);
                        *(f32x4*)(Z + off + bj * 128 + n * 16) = xv * ALPHA + gv[bj][n] * acc[ai][bj][m][n]; }
                asm volatile("" ::: "memory"); }
    }
};

constexpr int VS = 136;
__device__ __forceinline__ int dmap(int i, int r) { return 32 * (i >> 1) + 8 * (r >> 2) + 4 * (i & 1) + (r & 3); }

__device__ void mix_phase(const Params& p, int l, LAS unsigned char* lds) {
    const int tid = opaque_tid(), lane = tid & 63, wave = __builtin_amdgcn_readfirstlane(tid >> 6), fr = lane & 15, fq = lane >> 4;
    const bf16_t* proj = (const bf16_t*)(p.ws + WS_PROJ); bf16_t* ymix = (bf16_t*)(p.ws + WS_H);
    LAS bf16_t* T0 = (LAS bf16_t*)lds;
    LAS bf16_t* T1 = (LAS bf16_t*)(lds + 34816);
    LAS bf16_t* XA = (LAS bf16_t*)(lds + 69632);
    for (int item = blockIdx.x; item < 1024; item += gridDim.x) {
        const int tile = item & 127, j = item >> 7, n = tile & 15, R0 = (tile >> 4) * SEQ + n * 128;
        __syncthreads();
        f32x4 acc[8];
#pragma unroll
        for (int i = 0; i < 8; ++i) acc[i] = (f32x4){0.f, 0.f, 0.f, 0.f};
        if (j >= 4) {
            const int h = j - 4, lh = l * 4 + h;
            const bf16_t* vsrc = proj + (size_t)R0 * NP + 1536 + h * 128 + (tid & 15) * 8;
            u32x4 raw[4];
#pragma unroll
            for (int ps = 0; ps < 4; ++ps) raw[ps] = *(const u32x4*)(vsrc + (size_t)(ps * 32 + (tid >> 4)) * NP);
            const bf16_t* wrow = (const bf16_t*)(p.ws + WS_WSGU) + ((size_t)lh * 128 + 16 * wave + fr) * 128 + 8 * fq;
            bf16x8 bfr[4];
#pragma unroll
            for (int kk = 0; kk < 4; ++kk) { bfr[kk] = (bf16x8){0, 0, 0, 0, 0, 0, 0, 0}; if (kk <= (wave >> 1)) bfr[kk] = *(const bf16x8*)(wrow + 32 * kk); }
            const int d0 = (tid & 15) * 8;
            float lg[8], lb[8];
            { const f32x4 a = *(const f32x4*)(p.sgu_ln_g + lh * 128 + d0), b = *(const f32x4*)(p.sgu_ln_g + lh * 128 + d0 + 4), c = *(const f32x4*)(p.sgu_ln_b + lh * 128 + d0), d = *(const f32x4*)(p.sgu_ln_b + lh * 128 + d0 + 4);
#pragma unroll
              for (int i = 0; i < 4; ++i) { lg[i] = a[i]; lg[4 + i] = b[i]; lb[i] = c[i]; lb[4 + i] = d[i]; } }
#pragma unroll
            for (int ps = 0; ps < 4; ++ps) { float f[8]; unpack8(raw[ps], f);
                float s = ((f[0] + f[1]) + (f[2] + f[3])) + ((f[4] + f[5]) + (f[6] + f[7]));
                s += __shfl_xor(s, 1); s += __shfl_xor(s, 2); s += __shfl_xor(s, 4); s += __shfl_xor(s, 8);
                const float mean = s * (1.0f / 128.0f); float q = 0.f;
#pragma unroll
                for (int i = 0; i < 8; ++i) { f[i] -= mean; q += f[i] * f[i]; }
                q += __shfl_xor(q, 1); q += __shfl_xor(q, 2); q += __shfl_xor(q, 4); q += __shfl_xor(q, 8);
                const float rstd = rsqrtf(q * (1.0f / 128.0f) + EPS); const int srow = ps * 32 + (tid >> 4);
#pragma unroll
                for (int i = 0; i < 8; ++i) T0[(d0 + i) * VS + srow] = f2bf(f[i] * rstd * lg[i] + lb[i]); }
            __syncthreads();
#pragma unroll
            for (int kk = 0; kk < 4; ++kk) if (kk <= (wave >> 1)) {
#pragma unroll
                for (int i = 0; i < 8; ++i) { const bf16x8 a = *(const LAS bf16x8*)(T0 + dmap(i, fr) * VS + 32 * kk + 8 * fq);
                    acc[i] = __builtin_amdgcn_mfma_f32_16x16x32_bf16(a, bfr[kk], acc[i], 0, 0, 0); } }
            const int t = 16 * wave + fr; const float bs = p.b_sgu[lh * 128 + t];
            const bf16_t* urow = proj + (size_t)(R0 + t) * NP + 1024 + h * 128 + 8 * fq; const bf16_t* grow = urow + 1024;
            bf16_t* orow = ymix + (size_t)(R0 + t) * D + 512 + h * 128 + 8 * fq;
#pragma unroll
            for (int pp = 0; pp < 4; ++pp) { float uf[8], gf[8], o[8]; unpack8(*(const u32x4*)(urow + 32 * pp), uf); unpack8(*(const u32x4*)(grow + 32 * pp), gf);
#pragma unroll
                for (int k = 0; k < 4; ++k) { o[k] = uf[k] * (acc[2 * pp][k] + bs) * gf[k]; o[4 + k] = uf[4 + k] * (acc[2 * pp + 1][k] + bs) * gf[4 + k]; }
                *(u32x4*)(orow + 32 * pp) = pack8(o); }
        } else {
            const int g = j, w = 2 << g, lg_ = l * 4 + g;
            const bf16_t* xsrc = proj + (size_t)R0 * NP + g * 128;
            for (int idx = tid; idx < 144 * 16; idx += 512) { const int rr = idx >> 4, c0 = (idx & 15) * 8; u32x4 v = (u32x4){0u, 0u, 0u, 0u};
                if (n > 0 || rr >= 16) v = *(const u32x4*)(xsrc + ((long)rr - 16) * NP + c0);
                *(LAS u32x4*)(XA + rr * 128 + c0) = v; }
            const bf16_t* wp = (const bf16_t*)(p.ws + WS_WPOOL) + (size_t)lg_ * 16384;
            for (int idx = tid; idx < 128 * 16; idx += 512) { const int r = idx >> 4, c0 = (idx & 15) * 8; *(LAS u32x4*)(T1 + r * VS + c0) = *(const u32x4*)(wp + r * 128 + c0); }
            __syncthreads();
            { const int c = tid & 127, t0 = (tid >> 7) * 32; float sum = 0.f;
              for (int s = t0 - w + 1; s < t0; ++s) sum += bf2f(XA[(s + 16) * 128 + c]);
              for (int t = t0; t < t0 + 32; ++t) { const float xv = bf2f(XA[(t + 16) * 128 + c]); sum += xv;
                  const int pos = n * 128 + t, cnt = (pos + 1 < w) ? pos + 1 : w;
                  T0[t * VS + c] = f2bf(sum / (float)cnt - xv);
                  sum -= bf2f(XA[(t + 17 - w) * 128 + c]); } }
            __syncthreads();
#pragma unroll
            for (int kk = 0; kk < 4; ++kk) { const bf16x8 b = *(const LAS bf16x8*)(T0 + (16 * wave + fr) * VS + 32 * kk + 8 * fq);
#pragma unroll
                for (int i = 0; i < 8; ++i) { const bf16x8 a = *(const LAS bf16x8*)(T1 + dmap(i, fr) * VS + 32 * kk + 8 * fq);
                    acc[i] = __builtin_amdgcn_mfma_f32_16x16x32_bf16(a, b, acc[i], 0, 0, 0); } }
            const int s = 16 * wave + fr;
            const bf16_t* grow = proj + (size_t)(R0 + s) * NP + 512 + g * 128 + 8 * fq;
            bf16_t* orow = ymix + (size_t)(R0 + s) * D + g * 128 + 8 * fq;
            const float* psc = p.pool_scale + l * 512 + g * 128 + 8 * fq;
#pragma unroll
            for (int pp = 0; pp < 4; ++pp) { float gf[8], o[8]; unpack8(*(const u32x4*)(grow + 32 * pp), gf);
                const f32x4 s0 = *(const f32x4*)(psc + 32 * pp), s1 = *(const f32x4*)(psc + 32 * pp + 4);
#pragma unroll
                for (int k = 0; k < 4; ++k) { o[k] = acc[2 * pp][k] * s0[k] * gf[k]; o[4 + k] = acc[2 * pp + 1][k] * s1[k] * gf[4 + k]; }
                *(u32x4*)(orow + 32 * pp) = pack8(o); }
        }
    }
}

__global__ void __launch_bounds__(512) fwd_kernel(Params p) {
    extern __shared__ __attribute__((aligned(16))) unsigned char smem[];
    LAS unsigned char* lds = (LAS unsigned char*)smem;
    cg::grid_group grid = cg::this_grid();
    unsigned char* ws = p.ws;
    float* mod = (float*)(ws + WS_MOD); bf16_t* hb = (bf16_t*)(ws + WS_H); bf16_t* proj = (bf16_t*)(ws + WS_PROJ); float* z = (float*)(ws + WS_Z);

#ifndef PHM
#define PHM 63
#endif
    if (PHM & 1) p0_prologue(p, lds);
    grid.sync();
    if (PHM & 2) p1_lnmod(p.x, mod, hb);
    grid.sync();
#pragma unroll 1
    for (int l = 0; l < 2; ++l) {
        if (PHM & 4) { pg8::Gemm g{hb, (const bf16_t*)(ws + WS_WIN) + (size_t)l * NP * D, M, NP, D}; pg8::StaticOrder S; S.init(M, NP, (int)gridDim.x, (int)blockIdx.x);
          EpiProj E{proj}; pg8::gemm_phase<EpiProj, pg8::StaticOrder, false>(lds, g, S, E, nullptr); }
        grid.sync();
        if (PHM & 8) mix_phase(p, l, lds);
        grid.sync();
        if (PHM & 16) { pg8::Gemm g{hb, (const bf16_t*)(ws + WS_WOUT) + (size_t)l * D * D, M, D, D}; pg8::StaticOrder S; S.init(M, D, (int)gridDim.x, (int)blockIdx.x);
          EpiZ E{l == 0 ? p.x : (const float*)p.out, mod + (size_t)l * 8 * 3072 + 2048, z}; pg8::gemm_phase<EpiZ, pg8::StaticOrder, false>(lds, g, S, E, nullptr); }
        grid.sync();
        if (PHM & 32) p4_ln(z, p.ln_g + l * D, p.ln_b + l * D, p.out, l == 0 ? mod + (size_t)8 * 3072 : nullptr, hb);
        if (l == 0) grid.sync();
    }
}
}

extern "C" void kernel_launch(void* const* d_in, const int* in_sizes, int n_in, void* d_out, int out_size, void* d_ws, size_t ws_size, hipStream_t stream) {
    static int grid = 0;
    if (grid == 0) {
        if (n_in != 14 || ws_size < mk::WS_END) { fprintf(stderr, "kernel_launch: unexpected n_in %d / ws_size %zu (need %zu)\n", n_in, ws_size, (size_t)mk::WS_END); grid = -1; return; }
        int dev = 0, cus = 0, per_cu = 0;
        (void)hipGetDevice(&dev); (void)hipDeviceGetAttribute(&cus, hipDeviceAttributeMultiprocessorCount, dev);
        if (hipFuncSetAttribute((const void*)mk::fwd_kernel, hipFuncAttributeMaxDynamicSharedMemorySize, mk::LDS_BYTES) != hipSuccess) { fprintf(stderr, "kernel_launch: hipFuncSetAttribute failed\n"); grid = -1; return; }
        if (hipOccupancyMaxActiveBlocksPerMultiprocessor(&per_cu, (const void*)mk::fwd_kernel, 512, mk::LDS_BYTES) != hipSuccess || per_cu < 1) { fprintf(stderr, "kernel_launch: occupancy query says %d blocks per CU\n", per_cu); (void)hipGetLastError(); per_cu = 1; }
        grid = cus * per_cu;
    }
    if (grid < 0) return;
    mk::Params p{};
    p.x = (const float*)d_in[0]; p.c = (const float*)d_in[1]; p.w_ada = (const float*)d_in[2]; p.b_ada = (const float*)d_in[3]; p.w_in = (const float*)d_in[4];
    p.w_pool = (const float*)d_in[5]; p.pool_scale = (const float*)d_in[6]; p.sgu_ln_g = (const float*)d_in[7]; p.sgu_ln_b = (const float*)d_in[8]; p.w_sgu = (const float*)d_in[9];
    p.b_sgu = (const float*)d_in[10]; p.w_out = (const float*)d_in[11]; p.ln_g = (const float*)d_in[12]; p.ln_b = (const float*)d_in[13];
    p.out = (float*)d_out; p.ws = (unsigned char*)d_ws;
    void* args[] = {&p};
    const hipError_t e = hipLaunchCooperativeKernel((const void*)mk::fwd_kernel, dim3(grid), dim3(512), args, mk::LDS_BYTES, stream);
    if (e != hipSuccess) fprintf(stderr, "kernel_launch: cooperative launch failed: %s (grid %d)\n", hipGetErrorString(e), grid);
}
```

```cpp
#include <hip/hip_runtime.h>
#include <hip/hip_cooperative_groups.h>
#include <cstdio>
namespace cg = cooperative_groups;
namespace pg8 {
#define PG8_LAS __attribute__((address_space(3)))
typedef unsigned short bf16_t;
typedef short bf16x8 __attribute__((ext_vector_type(8)));
typedef float f32x4 __attribute__((ext_vector_type(4)));
typedef unsigned u32x4 __attribute__((ext_vector_type(4)));
constexpr int BM = 256, BK = 64, HALF = 128, HTB = HALF * BK * 2  , STAGE_BYTES = 8 * HTB, NXCD = 8, WGM = 8;

__host__ __device__ __forceinline__ int lds_byte(int r, int c) { const int st = (r >> 4) * 2 + (c >> 5), rr = r & 15, cc = c & 31, ob = rr * 64 + cc * 2; return st * 1024 + (ob ^ (((ob >> 9) & 1) << 5)); }
__host__ __device__ __forceinline__ void stage_rc(int b, int& R, int& C) { const int st = b / 1024, sb = b % 1024, swz = sb ^ (((sb >> 9) & 1) << 5); R = (st >> 1) * 16 + swz / 64; C = (st & 1) * 32 + (swz % 64) / 2; }
__host__ __device__ __forceinline__ int perm32(int rho) { const int n = rho >> 4, i = rho & 15; return 8 * (i >> 2) + 4 * n + (i & 3); }

struct Unit { int pm, pn; };
struct Gemm { const bf16_t* A; const bf16_t* Bt; int M, N, K; };

struct StaticOrder {
    int nM, nN, nwg, G, c;
    __host__ __device__ void init(int M, int N, int G_, int c_) { nM = M / BM; nN = N / BM; nwg = nM * nN; G = G_; c = c_; }
    __host__ __device__ bool next(int i, Unit& u) const {
        const long L = (long)i * G + c; if (L >= nwg) return false;
        int wgid = (int)L; { const int q = nwg / NXCD, r = nwg % NXCD, xcd = wgid % NXCD, off = wgid / NXCD; wgid = (xcd < r ? xcd * (q + 1) : r * (q + 1) + (xcd - r) * q) + off; }
        const int nig = WGM * nN, gid = wgid / nig, fm = gid * WGM, gsz = (nM - fm) < WGM ? (nM - fm) : WGM;
        u.pm = fm + ((wgid % nig) % gsz); u.pn = (wgid % nig) / gsz; return true;
    }
    __device__ __forceinline__ void a_ready(const Unit&) const {}
    __device__ __forceinline__ void done(const Unit&) const {}
};
struct CountedOrder : StaticOrder {
    const unsigned* ready; unsigned need; unsigned* tmo;
    __device__ __forceinline__ void a_ready(const Unit& u) const {
        if (threadIdx.x < 64) {
            const unsigned long long t0 = __builtin_amdgcn_s_memrealtime(); unsigned polls = 0;
            while ((unsigned)__builtin_amdgcn_readfirstlane(__hip_atomic_load(ready + 64 * u.pm, __ATOMIC_RELAXED, __HIP_MEMORY_SCOPE_AGENT)) < need) {
                if ((++polls & 255u) == 0u && __builtin_amdgcn_readfirstlane(__hip_atomic_load(tmo, __ATOMIC_RELAXED, __HIP_MEMORY_SCOPE_AGENT)) != 0u) break;
                if (__builtin_amdgcn_s_memrealtime() - t0 > 2000000ull) {
                    if (threadIdx.x == 0) { unsigned expect = 0u; __hip_atomic_compare_exchange_strong(tmo + 1, &expect, 0x600u | (unsigned)(u.pm & 0xff), __ATOMIC_RELAXED, __ATOMIC_RELAXED, __HIP_MEMORY_SCOPE_AGENT); __hip_atomic_store(tmo, 1u, __ATOMIC_RELAXED, __HIP_MEMORY_SCOPE_AGENT); }
                    break; }
                __builtin_amdgcn_s_sleep(2); }
            __builtin_amdgcn_fence(__ATOMIC_ACQUIRE, "agent");
            asm volatile("s_waitcnt vmcnt(0)" ::: "memory");
        }
#if !defined(BROKEN_HOOK_NO_BARRIER)
        asm volatile("" ::: "memory"); __builtin_amdgcn_s_barrier(); asm volatile("" ::: "memory");
#endif
    }
};

__device__ __forceinline__ unsigned cvt_pk_bf16(float lo, float hi) { unsigned r; asm volatile("v_cvt_pk_bf16_f32 %0, %1, %2" : "=v"(r) : "v"(lo), "v"(hi)); return r; }
typedef float f32x2 __attribute__((ext_vector_type(2)));
__device__ __forceinline__ f32x2 gelu_pk(f32x2 v) {
    const f32x2 av = __builtin_elementwise_abs(v), d = av * 0.2316418882f + 1.0f;
    f32x2 t; t.x = __builtin_amdgcn_rcpf(d.x); t.y = __builtin_amdgcn_rcpf(d.y);
    f32x2 q = t * 0.5307027145f + (-0.7265760135f); q = q * t + 0.7107068705f; q = q * t + (-0.142248368f); q = q * t + 0.127414796f; q = q * t;
    const f32x2 s = (v * v) * (-0.72134752044f);
    f32x2 e; e.x = __builtin_amdgcn_exp2f(s.x); e.y = __builtin_amdgcn_exp2f(s.y);
    const f32x2 m = v * (q * e), r = v - m;
    f32x2 o; o.x = v.x < 0.f ? m.x : r.x; o.y = v.y < 0.f ? m.y : r.y; return o;
}
template <class Epi, class Sched, bool STAMP = false>
__device__ __forceinline__ void gemm_phase(PG8_LAS unsigned char* lds, const Gemm g, const Sched& S, const Epi& E, unsigned long long* stamps) {
    int tid_ = threadIdx.x; asm volatile("" : "+v"(tid_)); const int tid = tid_, wid = __builtin_amdgcn_readfirstlane(tid >> 6), lane = tid & 63, wr = wid >> 2, wc = wid & 3, fr = lane & 15, fq = lane >> 4;
    const int K = g.K, nt = K / BK;
    int ts_lo = 0, ts_hi = 0, nts = 0; const unsigned long long rt_entry = STAMP ? (unsigned long long)wall_clock64() : 0ull;
#define PG8_STAMP() do { if (STAMP && wid == 0 && nts < 64) { const unsigned long long _c = (unsigned long long)clock64(); \
        ts_lo = (lane == nts) ? (int)(unsigned)_c : ts_lo; ts_hi = (lane == nts) ? (int)(unsigned)(_c >> 32) : ts_hi; ++nts; } } while (0)
    PG8_STAMP();
    unsigned voffA[2], voffB[2];
#pragma unroll
    for (int i = 0; i < 2; ++i) { int R, C; stage_rc(tid * 16 + i * 8192, R, C); const int Rb = Epi::PERM ? ((R & ~31) + perm32(R & 31)) : R;
        voffA[i] = (unsigned)(R * K + C) * 2u; voffB[i] = (unsigned)(Rb * K + C) * 2u; }
    const size_t kstep = (size_t)(BK * 2);
    const size_t hstep = (size_t)HALF * K * 2;
    const size_t tstep = 2 * hstep;
    const unsigned ldsw = (unsigned)wid * 1024u;
    const int aoff = lds_byte(wr * 64 + fr, fq * 8), boff = lds_byte(wc * 32 + fr, fq * 8);
#define PG8_SA(b, h) (((b) * 2 + (h)) * HTB)
#define PG8_SB(b, h) ((4 + (b) * 2 + (h)) * HTB)
#define PG8_STAGE(bufoff, gbase, voff) do { _Pragma("unroll") for (int _i = 0; _i < 2; ++_i) \
        __builtin_amdgcn_global_load_lds((const unsigned*)((const char*)(gbase) + (voff)[_i]), (PG8_LAS unsigned*)(lds + (bufoff) + ldsw + _i * 8192), 16, 0, 0); } while (0)
#define PG8_LDA(dst, b, h) do { _Pragma("unroll") for (int m = 0; m < 4; ++m) _Pragma("unroll") for (int k = 0; k < 2; ++k) dst[m][k] = *(const PG8_LAS bf16x8*)(lds + PG8_SA(b, h) + aoff + m * 2048 + k * 1024); } while (0)
#define PG8_LDB(dst, b, h) do { _Pragma("unroll") for (int n = 0; n < 2; ++n) _Pragma("unroll") for (int k = 0; k < 2; ++k) dst[n][k] = *(const PG8_LAS bf16x8*)(lds + PG8_SB(b, h) + boff + n * 2048 + k * 1024); } while (0)
#define PG8_MMA(ai, bj, At, Bt) do { __builtin_amdgcn_s_setprio(1); _Pragma("unroll") for (int m = 0; m < 4; ++m) _Pragma("unroll") for (int n = 0; n < 2; ++n) _Pragma("unroll") for (int k = 0; k < 2; ++k) \
        acc[ai][bj][m][n] = __builtin_amdgcn_mfma_f32_16x16x32_bf16(Bt[n][k], At[m][k], acc[ai][bj][m][n], 0, 0, 0); __builtin_amdgcn_s_setprio(0); } while (0)
#define PG8_WAIT_V(n) asm volatile("s_waitcnt vmcnt(" #n ")" ::: "memory")
#define PG8_WAIT_L(n) asm volatile("s_waitcnt lgkmcnt(" #n ")" ::: "memory")
#define PG8_BAR __builtin_amdgcn_s_barrier()
#define PG8_SCHED __builtin_amdgcn_sched_barrier(0)
    Unit cur, nxt; int ui = 0;
    if (!S.next(0, cur)) return;
    f32x4 acc[2][2][4][2];
#pragma unroll
    for (int a = 0; a < 2; ++a)
#pragma unroll
        for (int b = 0; b < 2; ++b)
#pragma unroll
            for (int m = 0; m < 4; ++m)
#pragma unroll
                for (int n = 0; n < 2; ++n) acc[a][b][m][n] = (f32x4){0.f, 0.f, 0.f, 0.f};
    bf16x8 At[4][2], B0[2][2], B1[2][2];
    const char* cA = (const char*)g.A + (size_t)cur.pm * tstep; const char* cB = (const char*)g.Bt + (size_t)cur.pn * tstep;
    S.a_ready(cur);
    PG8_STAGE(PG8_SB(0, 0), cB, voffB); PG8_STAGE(PG8_SA(0, 0), cA, voffA); PG8_STAGE(PG8_SB(0, 1), cB + hstep, voffB); PG8_STAGE(PG8_SA(0, 1), cA + hstep, voffA);
    if (wr == 1) PG8_BAR;
    PG8_WAIT_V(4); PG8_BAR;
    PG8_STAGE(PG8_SB(1, 0), cB + kstep, voffB); PG8_STAGE(PG8_SA(1, 0), cA + kstep, voffA); PG8_STAGE(PG8_SB(1, 1), cB + hstep + kstep, voffB);
    PG8_WAIT_V(6); PG8_BAR;
    PG8_STAMP();
    for (;;) {
        const bool has_next = S.next(ui + 1, nxt);
        const char* nA = has_next ? (const char*)g.A + (size_t)nxt.pm * tstep : cA; const char* nB = has_next ? (const char*)g.Bt + (size_t)nxt.pn * tstep : cB;
        for (int t = 0; t < nt; t += 2) {
            const bool last = (t == nt - 2);
            const char* a1 = cA + (size_t)(t + 1) * kstep;
            const char* a2 = last ? nA : cA + (size_t)(t + 2) * kstep; const char* b2 = last ? nB : cB + (size_t)(t + 2) * kstep;
            const char* a3 = a2 + kstep; const char* b3 = b2 + kstep;
            if (last && has_next) S.a_ready(nxt);
            PG8_LDB(B0, 0, 0); PG8_SCHED; PG8_LDA(At, 0, 0); PG8_STAGE(PG8_SA(1, 1), a1 + hstep, voffA);
            PG8_WAIT_L(8); PG8_BAR; PG8_WAIT_L(0); PG8_MMA(0, 0, At, B0); PG8_BAR; PG8_SCHED;
            PG8_LDB(B1, 0, 1); PG8_STAGE(PG8_SB(0, 0), b2, voffB);
            PG8_BAR; PG8_WAIT_L(0); PG8_MMA(0, 1, At, B1); PG8_BAR;
            PG8_LDA(At, 0, 1); PG8_STAGE(PG8_SA(0, 0), a2, voffA);
            PG8_BAR; PG8_WAIT_L(0); PG8_MMA(1, 0, At, B0); PG8_BAR; PG8_SCHED;
            PG8_STAGE(PG8_SB(0, 1), b2 + hstep, voffB);
            PG8_WAIT_V(6); PG8_BAR; PG8_MMA(1, 1, At, B1); PG8_BAR;
            PG8_LDB(B0, 1, 0); PG8_SCHED; PG8_LDA(At, 1, 0); PG8_STAGE(PG8_SA(0, 1), a2 + hstep, voffA);
            PG8_WAIT_L(8); PG8_BAR; PG8_WAIT_L(0); PG8_MMA(0, 0, At, B0); PG8_BAR; PG8_SCHED;
            PG8_LDB(B1, 1, 1); PG8_STAGE(PG8_SB(1, 0), b3, voffB);
            PG8_BAR; PG8_WAIT_L(0); PG8_MMA(0, 1, At, B1); PG8_BAR;
            PG8_LDA(At, 1, 1); PG8_STAGE(PG8_SA(1, 0), a3, voffA);
            PG8_BAR; PG8_WAIT_L(0); PG8_MMA(1, 0, At, B0); PG8_BAR; PG8_SCHED;
            PG8_STAGE(PG8_SB(1, 1), b3 + hstep, voffB);
            PG8_WAIT_V(6); PG8_BAR; PG8_MMA(1, 1, At, B1); PG8_BAR;
        }
        PG8_STAMP();
        if constexpr (!Epi::AFTER_DRAIN) { E(acc, cur, wr, wc, fr, fq); S.done(cur); }
        PG8_STAMP();
        if (!has_next) break;
#pragma unroll
        for (int a = 0; a < 2; ++a)
#pragma unroll
            for (int b = 0; b < 2; ++b)
#pragma unroll
                for (int m = 0; m < 4; ++m)
#pragma unroll
                    for (int n = 0; n < 2; ++n) acc[a][b][m][n] = (f32x4){0.f, 0.f, 0.f, 0.f};
        cur = nxt; cA = nA; cB = nB; ++ui;
    }
    PG8_WAIT_V(0);
    if (wr == 0) PG8_BAR;
    PG8_BAR;
    if constexpr (Epi::AFTER_DRAIN) { E.fused(acc, cur, wr, wc, fr, fq, lds, wid, lane); S.done(cur); }
    PG8_STAMP();
    if (STAMP && wid == 0) { stamps[lane] = lane < nts ? (((unsigned long long)(unsigned)ts_hi << 32) | (unsigned)ts_lo) : 0ull;
        if (lane == 62) stamps[62] = rt_entry; if (lane == 63) stamps[63] = (unsigned long long)wall_clock64(); }
#undef PG8_STAMP
#undef PG8_SA
#undef PG8_SB
#undef PG8_STAGE
#undef PG8_LDA
#undef PG8_LDB
#undef PG8_MMA
#undef PG8_WAIT_V
#undef PG8_WAIT_L
#undef PG8_BAR
#undef PG8_SCHED
}
}
#define LAS __attribute__((address_space(3)))
#define XB_TMO      128
#define XB_XCNT(j)  (256  + 64 * (j))
#define XB_XSUB(j)  (1280 + 64 * (j))
#define XB_XGEN(j)  (2304 + 64 * (j))
#define XB_TOP      3328
#define XB_TOPGEN   3392
#define XCD_BAR_WORDS 3456
#define XB_SPIN_CAP (1u << 18)

__device__ __forceinline__ unsigned xb_ld(unsigned* p)              { return __hip_atomic_load(p, __ATOMIC_RELAXED, __HIP_MEMORY_SCOPE_AGENT); }
__device__ __forceinline__ unsigned xb_add(unsigned* p, unsigned v) { return __hip_atomic_fetch_add(p, v, __ATOMIC_RELAXED, __HIP_MEMORY_SCOPE_AGENT); }
__device__ __forceinline__ unsigned xb_xcc_id() { return (unsigned)__builtin_amdgcn_s_getreg((3 << 11) | 20) & 0xFu; }
#define XB_SPIN(cond, bar) do { unsigned _sp = 0; while (cond) { __builtin_amdgcn_s_sleep(1); \
    if ((++_sp & 255u) == 0u) { if (xb_ld(&(bar)[XB_TMO])) break; if (_sp > XB_SPIN_CAP) { atomicAdd(&(bar)[XB_TMO], 1u); break; } } } } while (0)

struct XcdBarrier {
    unsigned* bar; unsigned x;
    volatile LAS unsigned* st;
};

__device__ __forceinline__ XcdBarrier xcd_barrier_post(unsigned* bar, volatile LAS unsigned* st) {
    XcdBarrier b; b.bar = bar; b.x = xb_xcc_id(); b.st = st;
    if (threadIdx.x == 0) (void)xb_add(&bar[XB_XCNT(b.x)], 1u);
    return b;
}
__device__ __forceinline__ void xcd_barrier_complete(unsigned* bar, unsigned x, unsigned& nloc, unsigned& nx) {
    const unsigned G = gridDim.x * gridDim.y * gridDim.z;
    unsigned sum, cnt, mine, sp = 0u;
    for (;;) {
        sum = 0u; cnt = 0u; mine = 0u;
#pragma unroll
        for (unsigned j = 0; j < 16; ++j) { const unsigned c = xb_ld(&bar[XB_XCNT(j)]); sum += c; cnt += (c > 0u) ? 1u : 0u; mine = (j == x) ? c : mine; }
        if (sum == G) break;
        __builtin_amdgcn_s_sleep(1);
        if ((++sp & 255u) == 0u) { if (xb_ld(&bar[XB_TMO])) break; if (sp > XB_SPIN_CAP) { atomicAdd(&bar[XB_TMO], 1u); break; } }
    }
    nloc = mine > 0u ? mine : 1u; nx = cnt > 0u ? cnt : 1u;
}

__device__ __forceinline__ void xcd_barrier(const XcdBarrier& b) {
    asm volatile("s_waitcnt vmcnt(0)" ::: "memory");
    __syncthreads();
    if (threadIdx.x == 0) {
        unsigned* bar = b.bar;
        __builtin_amdgcn_s_waitcnt(0);
        unsigned nloc = b.st[0], nx = b.st[1];
        if (nloc == 0u) { xcd_barrier_complete(bar, b.x, nloc, nx); b.st[0] = nloc; b.st[1] = nx; }
        const unsigned old = xb_add(&bar[XB_XSUB(b.x)], 1u);
        const unsigned gen = old / nloc;
        if (old + 1u == (gen + 1u) * nloc) {
            __builtin_amdgcn_fence(__ATOMIC_RELEASE, "agent");
            asm volatile("s_waitcnt vmcnt(0)" ::: "memory");
            const unsigned og = xb_add(&bar[XB_TOP], 1u);
            const unsigned tg = og / nx;
            if (og + 1u == (tg + 1u) * nx) xb_add(&bar[XB_TOPGEN], 1u);
            else XB_SPIN(xb_ld(&bar[XB_TOPGEN]) == tg, bar);
            __builtin_amdgcn_fence(__ATOMIC_ACQUIRE, "agent");
            xb_add(&bar[XB_XGEN(b.x)], 1u);
            asm volatile("s_waitcnt vmcnt(0)" ::: "memory");
        } else {
            XB_SPIN(xb_ld(&bar[XB_XGEN(b.x)]) == gen, bar);
            __builtin_amdgcn_fence(__ATOMIC_ACQUIRE, "agent");
            asm volatile("s_waitcnt vmcnt(0)" ::: "memory");
        }
    }
    __syncthreads();
}


namespace mk {
using pg8::bf16_t; using pg8::bf16x8; using pg8::f32x4; using pg8::u32x4; using pg8::f32x2; using pg8::Unit; using pg8::cvt_pk_bf16; using pg8::gelu_pk;
typedef unsigned u32x2 __attribute__((ext_vector_type(2)));

constexpr int NB = 8, SEQ = 2048, D = 1024, M = NB * SEQ, NP = 2560;
constexpr float ALPHA = 1.4142135623730951f;
constexpr float EPS = 1e-5f;
constexpr int LDS_BYTES = pg8::STAGE_BYTES + 16;

constexpr size_t WS_MOD = 0;
constexpr size_t WS_WIN = WS_MOD + (size_t)2 * 8 * 3072 * 4;
constexpr size_t WS_WOUT = WS_WIN + (size_t)2 * NP * D * 2;
constexpr size_t WS_WPOOL = WS_WOUT + (size_t)2 * D * D * 2;
constexpr size_t WS_WSGU = WS_WPOOL + (size_t)2 * 4 * 128 * 128 * 2;
constexpr size_t WS_H = WS_WSGU + (size_t)2 * 4 * 128 * 128 * 2;
constexpr size_t WS_PROJ = WS_H + (size_t)M * D * 2;
constexpr size_t WS_Z = WS_PROJ + (size_t)M * NP * 2;
constexpr size_t WS_BAR = WS_Z + (size_t)M * D * 4;
constexpr size_t WS_END = WS_BAR + (size_t)XCD_BAR_WORDS * 4;

struct Params { const float *x, *c, *w_ada, *b_ada, *w_in, *w_pool, *pool_scale, *sgu_ln_g, *sgu_ln_b, *w_sgu, *b_sgu, *w_out, *ln_g, *ln_b; float* out; unsigned char* ws; };

__device__ __forceinline__ int opaque_tid() { int t = threadIdx.x; asm volatile("" : "+v"(t)); return t; }
__device__ __forceinline__ float bf2f(unsigned short b) { return __uint_as_float((unsigned)b << 16); }
__device__ __forceinline__ unsigned short f2bf(float f) { unsigned u = __float_as_uint(f); u += 0x7FFFu + ((u >> 16) & 1u); return (unsigned short)(u >> 16); }
__device__ __forceinline__ float silu_f(float v) { return v * __builtin_amdgcn_rcpf(1.0f + __builtin_amdgcn_exp2f(-1.4426950408889634f * v)); }
__device__ __forceinline__ void unpack8(const u32x4 w, float (&f)[8]) {
    f[0] = __uint_as_float(w.x << 16); f[1] = __uint_as_float(w.x & 0xffff0000u); f[2] = __uint_as_float(w.y << 16); f[3] = __uint_as_float(w.y & 0xffff0000u);
    f[4] = __uint_as_float(w.z << 16); f[5] = __uint_as_float(w.z & 0xffff0000u); f[6] = __uint_as_float(w.w << 16); f[7] = __uint_as_float(w.w & 0xffff0000u);
}
__device__ __forceinline__ u32x4 pack8(const float (&f)[8]) { u32x4 w; w.x = cvt_pk_bf16(f[0], f[1]); w.y = cvt_pk_bf16(f[2], f[3]); w.z = cvt_pk_bf16(f[4], f[5]); w.w = cvt_pk_bf16(f[6], f[7]); return w; }

__device__ __forceinline__ void transpose_tile(const float* src, int ld_src, bf16_t* dst, int ld_dst, LAS float* tile, int tid) {
    __syncthreads();
#pragma unroll
    for (int pass = 0; pass < 2; ++pass) { const int r = pass * 32 + (tid >> 4), c4 = (tid & 15) * 4; const f32x4 v = *(const f32x4*)(src + (size_t)r * ld_src + c4);
        tile[r * 65 + c4 + 0] = v[0]; tile[r * 65 + c4 + 1] = v[1]; tile[r * 65 + c4 + 2] = v[2]; tile[r * 65 + c4 + 3] = v[3]; }
    __syncthreads();
    const int c = tid >> 3, r8 = (tid & 7) * 8; float f[8];
#pragma unroll
    for (int i = 0; i < 8; ++i) f[i] = tile[(r8 + i) * 65 + c];
    *(u32x4*)(dst + (size_t)c * ld_dst + r8) = pack8(f);
}
__device__ void p0_prologue(const Params& p, LAS unsigned char* lds) {
    const int tid = opaque_tid();
    LAS float* sc = (LAS float*)lds;
    LAS float* red = (LAS float*)(lds + 32768);
    LAS float* tile = (LAS float*)(lds + 49152);
    unsigned char* ws = p.ws;
    for (int i = tid; i < 8192; i += 512) sc[i] = silu_f(p.c[i]);
    __syncthreads();
    constexpr int N_MOD = 384, N_TIN = 1280, N_TOUT = 512, N_TPOOL = 32, N_SGU = 32, N_ALL = N_MOD + N_TIN + N_TOUT + N_TPOOL + N_SGU;
    for (int it = blockIdx.x; it < N_ALL; it += gridDim.x) {
        if (it < N_MOD) {
            const int l = it / 192, n0 = (it % 192) * 16, kq = tid >> 4, nn = tid & 15;
            const float* wp = p.w_ada + (size_t)l * 1024 * 3072 + (size_t)(kq * 32) * 3072 + n0 + nn;
            float acc[8];
#pragma unroll
            for (int b = 0; b < 8; ++b) acc[b] = 0.f;
#pragma unroll 8
            for (int kk = 0; kk < 32; ++kk) { const float w = wp[(size_t)kk * 3072];
#pragma unroll
                for (int b = 0; b < 8; ++b) acc[b] += sc[b * 1024 + kq * 32 + kk] * w; }
            __syncthreads();
#pragma unroll
            for (int b = 0; b < 8; ++b) red[kq * 128 + nn * 8 + b] = acc[b];
            __syncthreads();
            if (tid < 128) { float s = 0.f;
                for (int q = 0; q < 32; ++q) s += red[q * 128 + tid];
                const int n = n0 + (tid >> 3), b = tid & 7;
                ((float*)(ws + WS_MOD))[(size_t)(l * 8 + b) * 3072 + n] = s + p.b_ada[l * 3072 + n]; }
        } else if (it < N_MOD + N_TIN) {
            const int i2 = it - N_MOD, l = i2 / 640, r = i2 % 640, kt = r / 40, nt = r % 40;
            transpose_tile(p.w_in + (size_t)l * D * NP + (size_t)kt * 64 * NP + nt * 64, NP, (bf16_t*)(ws + WS_WIN) + (size_t)l * NP * D + (size_t)nt * 64 * D + kt * 64, D, tile, tid);
        } else if (it < N_MOD + N_TIN + N_TOUT) {
            const int i2 = it - N_MOD - N_TIN, l = i2 / 256, r = i2 % 256, kt = r / 16, nt = r % 16;
            transpose_tile(p.w_out + (size_t)l * D * D + (size_t)kt * 64 * D + nt * 64, D, (bf16_t*)(ws + WS_WOUT) + (size_t)l * D * D + (size_t)nt * 64 * D + kt * 64, D, tile, tid);
        } else if (it < N_MOD + N_TIN + N_TOUT + N_TPOOL) {
            const int i2 = it - N_MOD - N_TIN - N_TOUT, lg = i2 / 4, r = i2 % 4, kt = r / 2, nt = r % 2;
            transpose_tile(p.w_pool + (size_t)lg * 16384 + (size_t)kt * 64 * 128 + nt * 64, 128, (bf16_t*)(ws + WS_WPOOL) + (size_t)lg * 16384 + (size_t)nt * 64 * 128 + kt * 64, 128, tile, tid);
        } else {
            const int i2 = it - N_MOD - N_TIN - N_TOUT - N_TPOOL; const size_t e0 = (size_t)i2 * 4096 + (size_t)tid * 8;
            const int s0 = (int)(e0 & 127), t = (int)((e0 >> 7) & 127);
            const f32x4 a = *(const f32x4*)(p.w_sgu + e0), b = *(const f32x4*)(p.w_sgu + e0 + 4);
            float f[8] = {a[0], a[1], a[2], a[3], b[0], b[1], b[2], b[3]};
#pragma unroll
            for (int i = 0; i < 8; ++i) if (s0 + i > t) f[i] = 0.f;
            *(u32x4*)((bf16_t*)(ws + WS_WSGU) + e0) = pack8(f);
        }
    }
}

__device__ __forceinline__ void row_stats(const f32x4 (&v)[4], float& mean, float& rstd) {
    float s = 0.f;
#pragma unroll
    for (int i = 0; i < 4; ++i) s += (v[i][0] + v[i][1]) + (v[i][2] + v[i][3]);
#pragma unroll
    for (int o = 32; o >= 1; o >>= 1) s += __shfl_xor(s, o);
    mean = s * (1.0f / 1024.0f);
    float q = 0.f;
#pragma unroll
    for (int i = 0; i < 4; ++i) { const f32x4 d = v[i] - mean; q += (d[0] * d[0] + d[1] * d[1]) + (d[2] * d[2] + d[3] * d[3]); }
#pragma unroll
    for (int o = 32; o >= 1; o >>= 1) q += __shfl_xor(q, o);
    rstd = rsqrtf(q * (1.0f / 1024.0f) + EPS);
}
__device__ __forceinline__ void store_mod(const f32x4 (&v)[4], const float* modb, bf16_t* hrow, int lane) {
    float mean, rstd; row_stats(v, mean, rstd);
#pragma unroll
    for (int i = 0; i < 4; ++i) { const int col = i * 256 + lane * 4;
        const f32x4 sh = *(const f32x4*)(modb + col), scl = *(const f32x4*)(modb + 1024 + col);
        const f32x4 o = (v[i] - mean) * rstd * (scl + 1.0f) + sh;
        u32x2 w; w.x = cvt_pk_bf16(o[0], o[1]); w.y = cvt_pk_bf16(o[2], o[3]); *(u32x2*)(hrow + col) = w; }
}
__device__ void p1_lnmod(const float* src, const float* mod_l, bf16_t* hb) {
    const int tid = opaque_tid(), lane = tid & 63, wave = tid >> 6;
    for (int row = blockIdx.x * 8 + wave; row < M; row += gridDim.x * 8) {
        f32x4 v[4];
#pragma unroll
        for (int i = 0; i < 4; ++i) v[i] = *(const f32x4*)(src + (size_t)row * D + i * 256 + lane * 4);
        store_mod(v, mod_l + (size_t)(row >> 11) * 3072, hb + (size_t)row * D, lane);
    }
}
__device__ void p4_ln(const float* z, const float* g, const float* bta, float* out, const float* mod_next, bf16_t* hb) {
    const int tid = opaque_tid(), lane = tid & 63, wave = tid >> 6;
    for (int row = blockIdx.x * 8 + wave; row < M; row += gridDim.x * 8) {
        f32x4 v[4];
#pragma unroll
        for (int i = 0; i < 4; ++i) v[i] = *(const f32x4*)(z + (size_t)row * D + i * 256 + lane * 4);
        float mean, rstd; row_stats(v, mean, rstd);
#pragma unroll
        for (int i = 0; i < 4; ++i) { const int col = i * 256 + lane * 4;
            v[i] = (v[i] - mean) * rstd * *(const f32x4*)(g + col) + *(const f32x4*)(bta + col);
            *(f32x4*)(out + (size_t)row * D + col) = v[i]; }
        if (mod_next) store_mod(v, mod_next + (size_t)(row >> 11) * 3072, hb + (size_t)row * D, lane);
    }
}

struct EpiProj {
    static constexpr bool PERM = true, AFTER_DRAIN = false;
    bf16_t* O;
    template <int ACT> __device__ __forceinline__ void run(const f32x4 (&acc)[2][2][4][2], bf16_t* base) const {
#pragma unroll
        for (int ai = 0; ai < 2; ++ai)
#pragma unroll
            for (int m = 0; m < 4; ++m) { bf16_t* rowp = base + (size_t)(ai * 128 + m * 16) * NP;
#pragma unroll
                for (int bj = 0; bj < 2; ++bj) { f32x4 v0 = acc[ai][bj][m][0], v1 = acc[ai][bj][m][1];
                    if (ACT == 2) { const f32x2 a = gelu_pk((f32x2){v0[0], v0[1]}), b = gelu_pk((f32x2){v0[2], v0[3]}), c = gelu_pk((f32x2){v1[0], v1[1]}), d = gelu_pk((f32x2){v1[2], v1[3]});
                        v0 = (f32x4){a.x, a.y, b.x, b.y}; v1 = (f32x4){c.x, c.y, d.x, d.y}; }
                    if (ACT == 1) {
#pragma unroll
                        for (int j = 0; j < 4; ++j) { v0[j] = silu_f(v0[j]); v1[j] = silu_f(v1[j]); } }
                    u32x4 w; w.x = cvt_pk_bf16(v0[0], v0[1]); w.y = cvt_pk_bf16(v0[2], v0[3]); w.z = cvt_pk_bf16(v1[0], v1[1]); w.w = cvt_pk_bf16(v1[2], v1[3]);
                    *(u32x4*)(rowp + bj * 128) = w; } }
    }
    __device__ __forceinline__ void operator()(const f32x4 (&acc)[2][2][4][2], const Unit& u, int wr, int wc, int fr, int fq) const {
        bf16_t* base = O + (size_t)(u.pm * 256 + wr * 64 + fr) * NP + u.pn * 256 + wc * 32 + 8 * fq;
        const int pn = u.pn;
        if (pn < 2) run<0>(acc, base); else if (pn >= 4 && pn < 8) run<2>(acc, base); else run<1>(acc, base);
    }
};
struct EpiZ {
    static constexpr bool PERM = false, AFTER_DRAIN = false;
    const float* X; const float* gate; float* Z;
    __device__ __forceinline__ void operator()(const f32x4 (&acc)[2][2][4][2], const Unit& u, int wr, int wc, int fr, int fq) const {
        const int row0 = u.pm * 256 + wr * 64 + fr, col0 = u.pn * 256 + wc * 32 + 4 * fq;
        const float* gb = gate + (size_t)(u.pm >> 3) * 3072 + col0;
        f32x4 gv[2][2];
#pragma unroll
        for (int bj = 0; bj < 2; ++bj)
#pragma unroll
            for (int n = 0; n < 2; ++n) gv[bj][n] = *(const f32x4*)(gb + bj * 128 + n * 16);
#pragma unroll
        for (int ai = 0; ai < 2; ++ai)
#pragma unroll
            for (int m = 0; m < 4; ++m) { const size_t off = (size_t)(row0 + ai * 128 + m * 16) * D + col0;
#pragma unroll
                for (int bj = 0; bj < 2; ++bj)
#pragma unroll
                    for (int n = 0; n < 2; ++n) { const f32x4 xv = *(const f32x4*)(X + off + bj * 128 + n * 16);
                        *(f32x4*)(Z + off + bj * 128 + n * 16) = xv * ALPHA + gv[bj][n] * acc[ai][bj][m][n]; }
                asm volatile("" ::: "memory"); }
    }
};

constexpr int VS = 136;
__device__ __forceinline__ int dmap(int i, int r) { return 32 * (i >> 1) + 8 * (r >> 2) + 4 * (i & 1) + (r & 3); }

__device__ void mix_phase(const Params& p, int l, LAS unsigned char* lds) {
    const int tid = opaque_tid(), lane = tid & 63, wave = __builtin_amdgcn_readfirstlane(tid >> 6), fr = lane & 15, fq = lane >> 4;
    const bf16_t* proj = (const bf16_t*)(p.ws + WS_PROJ); bf16_t* ymix = (bf16_t*)(p.ws + WS_H);
    LAS bf16_t* T0 = (LAS bf16_t*)lds;
    LAS bf16_t* T1 = (LAS bf16_t*)(lds + 34816);
    LAS bf16_t* XA = (LAS bf16_t*)(lds + 69632);
    for (int item = blockIdx.x; item < 1024; item += gridDim.x) {
        const int tile = item & 127, j = item >> 7, n = tile & 15, R0 = (tile >> 4) * SEQ + n * 128;
        __syncthreads();
        f32x4 acc[8];
#pragma unroll
        for (int i = 0; i < 8; ++i) acc[i] = (f32x4){0.f, 0.f, 0.f, 0.f};
        if (j >= 4) {
            const int h = j - 4, lh = l * 4 + h;
            const bf16_t* vsrc = proj + (size_t)R0 * NP + 1536 + h * 128 + (tid & 15) * 8;
            u32x4 raw[4];
#pragma unroll
            for (int ps = 0; ps < 4; ++ps) raw[ps] = *(const u32x4*)(vsrc + (size_t)(ps * 32 + (tid >> 4)) * NP);
            const bf16_t* wrow = (const bf16_t*)(p.ws + WS_WSGU) + ((size_t)lh * 128 + 16 * wave + fr) * 128 + 8 * fq;
            bf16x8 bfr[4];
#pragma unroll
            for (int kk = 0; kk < 4; ++kk) { bfr[kk] = (bf16x8){0, 0, 0, 0, 0, 0, 0, 0}; if (kk <= (wave >> 1)) bfr[kk] = *(const bf16x8*)(wrow + 32 * kk); }
            const int d0 = (tid & 15) * 8;
            float lg[8], lb[8];
            { const f32x4 a = *(const f32x4*)(p.sgu_ln_g + lh * 128 + d0), b = *(const f32x4*)(p.sgu_ln_g + lh * 128 + d0 + 4), c = *(const f32x4*)(p.sgu_ln_b + lh * 128 + d0), d = *(const f32x4*)(p.sgu_ln_b + lh * 128 + d0 + 4);
#pragma unroll
              for (int i = 0; i < 4; ++i) { lg[i] = a[i]; lg[4 + i] = b[i]; lb[i] = c[i]; lb[4 + i] = d[i]; } }
#pragma unroll
            for (int ps = 0; ps < 4; ++ps) { float f[8]; unpack8(raw[ps], f);
                float s = ((f[0] + f[1]) + (f[2] + f[3])) + ((f[4] + f[5]) + (f[6] + f[7]));
                s += __shfl_xor(s, 1); s += __shfl_xor(s, 2); s += __shfl_xor(s, 4); s += __shfl_xor(s, 8);
                const float mean = s * (1.0f / 128.0f); float q = 0.f;
#pragma unroll
                for (int i = 0; i < 8; ++i) { f[i] -= mean; q += f[i] * f[i]; }
                q += __shfl_xor(q, 1); q += __shfl_xor(q, 2); q += __shfl_xor(q, 4); q += __shfl_xor(q, 8);
                const float rstd = rsqrtf(q * (1.0f / 128.0f) + EPS); const int srow = ps * 32 + (tid >> 4);
#pragma unroll
                for (int i = 0; i < 8; ++i) T0[(d0 + i) * VS + srow] = f2bf(f[i] * rstd * lg[i] + lb[i]); }
            __syncthreads();
#pragma unroll
            for (int kk = 0; kk < 4; ++kk) if (kk <= (wave >> 1)) {
#pragma unroll
                for (int i = 0; i < 8; ++i) { const bf16x8 a = *(const LAS bf16x8*)(T0 + dmap(i, fr) * VS + 32 * kk + 8 * fq);
                    acc[i] = __builtin_amdgcn_mfma_f32_16x16x32_bf16(a, bfr[kk], acc[i], 0, 0, 0); } }
            const int t = 16 * wave + fr; const float bs = p.b_sgu[lh * 128 + t];
            const bf16_t* urow = proj + (size_t)(R0 + t) * NP + 1024 + h * 128 + 8 * fq; const bf16_t* grow = urow + 1024;
            bf16_t* orow = ymix + (size_t)(R0 + t) * D + 512 + h * 128 + 8 * fq;
#pragma unroll
            for (int pp = 0; pp < 4; ++pp) { float uf[8], gf[8], o[8]; unpack8(*(const u32x4*)(urow + 32 * pp), uf); unpack8(*(const u32x4*)(grow + 32 * pp), gf);
#pragma unroll
                for (int k = 0; k < 4; ++k) { o[k] = uf[k] * (acc[2 * pp][k] + bs) * gf[k]; o[4 + k] = uf[4 + k] * (acc[2 * pp + 1][k] + bs) * gf[4 + k]; }
                *(u32x4*)(orow + 32 * pp) = pack8(o); }
        } else {
            const int g = j, w = 2 << g, lg_ = l * 4 + g;
            const bf16_t* xsrc = proj + (size_t)R0 * NP + g * 128;
            for (int idx = tid; idx < 144 * 16; idx += 512) { const int rr = idx >> 4, c0 = (idx & 15) * 8; u32x4 v = (u32x4){0u, 0u, 0u, 0u};
                if (n > 0 || rr >= 16) v = *(const u32x4*)(xsrc + ((long)rr - 16) * NP + c0);
                *(LAS u32x4*)(XA + rr * 128 + c0) = v; }
            const bf16_t* wp = (const bf16_t*)(p.ws + WS_WPOOL) + (size_t)lg_ * 16384;
            for (int idx = tid; idx < 128 * 16; idx += 512) { const int r = idx >> 4, c0 = (idx & 15) * 8; *(LAS u32x4*)(T1 + r * VS + c0) = *(const u32x4*)(wp + r * 128 + c0); }
            __syncthreads();
            { const int c = tid & 127, t0 = (tid >> 7) * 32; float sum = 0.f;
              for (int s = t0 - w + 1; s < t0; ++s) sum += bf2f(XA[(s + 16) * 128 + c]);
              for (int t = t0; t < t0 + 32; ++t) { const float xv = bf2f(XA[(t + 16) * 128 + c]); sum += xv;
                  const int pos = n * 128 + t, cnt = (pos + 1 < w) ? pos + 1 : w;
                  T0[t * VS + c] = f2bf(sum / (float)cnt - xv);
                  sum -= bf2f(XA[(t + 17 - w) * 128 + c]); } }
            __syncthreads();
#pragma unroll
            for (int kk = 0; kk < 4; ++kk) { const bf16x8 b = *(const LAS bf16x8*)(T0 + (16 * wave + fr) * VS + 32 * kk + 8 * fq);
#pragma unroll
                for (int i = 0; i < 8; ++i) { const bf16x8 a = *(const LAS bf16x8*)(T1 + dmap(i, fr) * VS + 32 * kk + 8 * fq);
                    acc[i] = __builtin_amdgcn_mfma_f32_16x16x32_bf16(a, b, acc[i], 0, 0, 0); } }
            const int s = 16 * wave + fr;
            const bf16_t* grow = proj + (size_t)(R0 + s) * NP + 512 + g * 128 + 8 * fq;
            bf16_t* orow = ymix + (size_t)(R0 + s) * D + g * 128 + 8 * fq;
            const float* psc = p.pool_scale + l * 512 + g * 128 + 8 * fq;
#pragma unroll
            for (int pp = 0; pp < 4; ++pp) { float gf[8], o[8]; unpack8(*(const u32x4*)(grow + 32 * pp), gf);
                const f32x4 s0 = *(const f32x4*)(psc + 32 * pp), s1 = *(const f32x4*)(psc + 32 * pp + 4);
#pragma unroll
                for (int k = 0; k < 4; ++k) { o[k] = acc[2 * pp][k] * s0[k] * gf[k]; o[4 + k] = acc[2 * pp + 1][k] * s1[k] * gf[4 + k]; }
                *(u32x4*)(orow + 32 * pp) = pack8(o); }
        }
    }
}

__global__ void __launch_bounds__(512) fwd_kernel(Params p) {
    extern __shared__ __attribute__((aligned(16))) unsigned char smem[];
    LAS unsigned char* lds = (LAS unsigned char*)smem;
    if (threadIdx.x == 0) { *(volatile LAS unsigned*)(lds + pg8::STAGE_BYTES) = 0u; *(volatile LAS unsigned*)(lds + pg8::STAGE_BYTES + 4) = 0u; }
    __syncthreads();
    const XcdBarrier bar = xcd_barrier_post((unsigned*)(p.ws + WS_BAR), (volatile LAS unsigned*)(lds + pg8::STAGE_BYTES));
#define GSYNC() xcd_barrier(bar)
    unsigned char* ws = p.ws;
    float* mod = (float*)(ws + WS_MOD); bf16_t* hb = (bf16_t*)(ws + WS_H); bf16_t* proj = (bf16_t*)(ws + WS_PROJ); float* z = (float*)(ws + WS_Z);

#ifndef PHM
#define PHM 63
#endif
#ifndef XSYNC
#define XSYNC 0
#endif
#ifndef REP_P0
#define REP_P0 1
#endif
#ifndef REP_P1
#define REP_P1 1
#endif
#ifndef REP_G1
#define REP_G1 1
#endif
#ifndef REP_MIX
#define REP_MIX 1
#endif
#ifndef REP_G2
#define REP_G2 1
#endif
#ifndef REP_P4
#define REP_P4 1
#endif
    for (int r = 0; r < REP_P0; ++r) { p0_prologue(p, lds); __syncthreads(); }
    GSYNC();
    for (int r = 0; r < XSYNC; ++r) GSYNC();
    for (int r = 0; r < REP_P1; ++r) p1_lnmod(p.x, mod, hb);
    GSYNC();
#pragma unroll 1
    for (int l = 0; l < 2; ++l) {
        for (int r = 0; r < REP_G1; ++r) { pg8::Gemm g{hb, (const bf16_t*)(ws + WS_WIN) + (size_t)l * NP * D, M, NP, D}; pg8::StaticOrder S; S.init(M, NP, (int)gridDim.x, (int)blockIdx.x);
          EpiProj E{proj}; pg8::gemm_phase<EpiProj, pg8::StaticOrder, false>(lds, g, S, E, nullptr); }
        GSYNC();
        for (int r = 0; r < REP_MIX; ++r) mix_phase(p, l, lds);
        GSYNC();
        for (int r = 0; r < REP_G2; ++r) { pg8::Gemm g{hb, (const bf16_t*)(ws + WS_WOUT) + (size_t)l * D * D, M, D, D}; pg8::StaticOrder S; S.init(M, D, (int)gridDim.x, (int)blockIdx.x);
          EpiZ E{l == 0 ? p.x : (const float*)p.out, mod + (size_t)l * 8 * 3072 + 2048, z}; pg8::gemm_phase<EpiZ, pg8::StaticOrder, false>(lds, g, S, E, nullptr); }
        GSYNC();
        for (int r = 0; r < REP_P4; ++r) p4_ln(z, p.ln_g + l * D, p.ln_b + l * D, p.out, l == 0 ? mod + (size_t)8 * 3072 : nullptr, hb);
        if (l == 0) GSYNC();
    }
}
}

extern "C" void kernel_launch(void* const* d_in, const int* in_sizes, int n_in, void* d_out, int out_size, void* d_ws, size_t ws_size, hipStream_t stream) {
    static int grid = 0;
    if (grid == 0) {
        if (n_in != 14 || ws_size < mk::WS_END) { fprintf(stderr, "kernel_launch: unexpected n_in %d / ws_size %zu (need %zu)\n", n_in, ws_size, (size_t)mk::WS_END); grid = -1; return; }
        int dev = 0, cus = 0, per_cu = 0;
        (void)hipGetDevice(&dev); (void)hipDeviceGetAttribute(&cus, hipDeviceAttributeMultiprocessorCount, dev);
        if (hipFuncSetAttribute((const void*)mk::fwd_kernel, hipFuncAttributeMaxDynamicSharedMemorySize, mk::LDS_BYTES) != hipSuccess) { fprintf(stderr, "kernel_launch: hipFuncSetAttribute failed\n"); grid = -1; return; }
        if (hipOccupancyMaxActiveBlocksPerMultiprocessor(&per_cu, (const void*)mk::fwd_kernel, 512, mk::LDS_BYTES) != hipSuccess || per_cu < 1) { fprintf(stderr, "kernel_launch: occupancy query says %d blocks per CU\n", per_cu); (void)hipGetLastError(); per_cu = 1; }
        grid = cus * per_cu;
    }
    if (grid < 0) return;
    mk::Params p{};
    p.x = (const float*)d_in[0]; p.c = (const float*)d_in[1]; p.w_ada = (const float*)d_in[2]; p.b_ada = (const float*)d_in[3]; p.w_in = (const float*)d_in[4];
    p.w_pool = (const float*)d_in[5]; p.pool_scale = (const float*)d_in[6]; p.sgu_ln_g = (const float*)d_in[7]; p.sgu_ln_b = (const float*)d_in[8]; p.w_sgu = (const float*)d_in[9];
    p.b_sgu = (const float*)d_in[10]; p.w_out = (const float*)d_in[11]; p.ln_g = (const float*)d_in[12]; p.ln_b = (const float*)d_in[13];
    p.out = (float*)d_out; p.ws = (unsigned char*)d_ws;
    if (hipMemsetAsync((unsigned char*)d_ws + mk::WS_BAR, 0, (size_t)XCD_BAR_WORDS * 4, stream) != hipSuccess) { fprintf(stderr, "kernel_launch: memset of the barrier words failed\n"); return; }
    void* args[] = {&p};
    const hipError_t e = hipLaunchCooperativeKernel((const void*)mk::fwd_kernel, dim3(grid), dim3(512), args, mk::LDS_BYTES, stream);
    if (e != hipSuccess) fprintf(stderr, "kernel_launch: cooperative launch failed: %s (grid %d)\n", hipGetErrorString(e), grid);
}
```
